# Optimizing an MI355X kernel written in HIP

```python
import jax, jax.numpy as jnp
from jax import lax
import numpy as np

D_MODEL = 2048
BATCH = 4
SEQ = 4096
DEPTH = 4

N_MIXERS = 2
N_CONV_LAYERS = (DEPTH + 1) // 2
N_POOL_LAYERS = DEPTH // 2
CONV_WIDTH = 3
POOL_WINDOWS = (2, 4, 8, 16)
N_POOL_GROUPS = len(POOL_WINDOWS)
GROUP_DIM = D_MODEL // N_POOL_GROUPS
D_FF = 5632
N_MOD = 9
EPS = 1e-6
FFN_RES_WEIGHT = 0.5

kernel_name = "hybrid_shortconv_pool_macaron_adaln"


def rmsnorm(x, g):
    xf = x.astype(jnp.float32)
    y = xf * lax.rsqrt(jnp.mean(xf * xf, axis=-1, keepdims=True) + EPS)
    return (y * g.astype(jnp.float32)).astype(x.dtype)


def modulate(h, shift, scale):
    return h * (1 + scale[:, None, :]) + shift[:, None, :]


def swiglu(h, w_in, w_out):
    gu = jnp.einsum('bsd,df->bsf', h, w_in)
    g, u = jnp.split(gu, 2, axis=-1)
    return jnp.einsum('bsf,fd->bsd', jax.nn.silu(g) * u, w_out)


def causal_shift(u, k):
    pad = [(0, 0)] * u.ndim
    pad[1] = (k, 0)
    return jnp.pad(u, pad)[:, :u.shape[1]]


def short_conv_mixer(h, w_in, w_conv, w_out):
    proj = jnp.einsum('bsd,de->bse', h, w_in)
    b_gate, c_gate, v = jnp.split(proj, 3, axis=-1)
    u = c_gate * v
    y = sum(w_conv[CONV_WIDTH - 1 - k] * causal_shift(u, k) for k in range(CONV_WIDTH))
    return jnp.einsum('bsd,de->bse', b_gate * y, w_out)


def pooling_mixer(h, w_group, scale):
    B, S, D = h.shape
    hg = h.reshape(B, S, N_POOL_GROUPS, GROUP_DIM).astype(jnp.float32)
    cs = jnp.cumsum(hg, axis=1)
    t = jnp.arange(S)
    outs = []
    for g, w in enumerate(POOL_WINDOWS):
        csg = cs[:, :, g]
        win_sum = csg - causal_shift(csg, w)
        count = jnp.minimum(t + 1, w).astype(jnp.float32)[None, :, None]
        outs.append(win_sum / count - hg[:, :, g])
    pooled = jnp.stack(outs, axis=2).astype(h.dtype)
    y = jnp.einsum('bsgc,gce->bsge', pooled, w_group).reshape(B, S, D)
    return y * scale


def setup_inputs(seed: int = 0) -> dict:
    key = jax.random.key(seed)
    ks = jax.random.split(key, 20)
    D, F = D_MODEL, D_FF
    f32 = jnp.float32

    def nrm(k, shape, std):
        return jax.random.normal(k, shape, f32) * std

    return {
        "x": nrm(ks[0], (BATCH, SEQ, D), 1.0),
        "c": nrm(ks[1], (BATCH, D), 1.0),
        "norm_ffn1": 1.0 + nrm(ks[2], (DEPTH, D), 0.05),
        "norm_mix": 1.0 + nrm(ks[3], (DEPTH, D), 0.05),
        "norm_ffn2": 1.0 + nrm(ks[4], (DEPTH, D), 0.05),
        "w_ada": nrm(ks[5], (DEPTH, D, N_MOD * D), 0.5 * D ** -0.5),
        "b_ada": nrm(ks[6], (DEPTH, N_MOD * D), 0.02),
        "w_ffn1_in": nrm(ks[7], (DEPTH, D, 2 * F), D ** -0.5),
        "w_ffn1_out": nrm(ks[8], (DEPTH, F, D), F ** -0.5),
        "w_ffn2_in": nrm(ks[9], (DEPTH, D, 2 * F), D ** -0.5),
        "w_ffn2_out": nrm(ks[10], (DEPTH, F, D), F ** -0.5),
        "conv_in": nrm(ks[11], (N_CONV_LAYERS, D, 3 * D), D ** -0.5),
        "conv_w": nrm(ks[12], (N_CONV_LAYERS, CONV_WIDTH, D), CONV_WIDTH ** -0.5),
        "conv_out": nrm(ks[13], (N_CONV_LAYERS, D, D), D ** -0.5),
        "pool_w": nrm(ks[14], (N_POOL_LAYERS, N_POOL_GROUPS, GROUP_DIM, GROUP_DIM), GROUP_DIM ** -0.5),
        "pool_scale": 1.0 + nrm(ks[15], (N_POOL_LAYERS, D), 0.1),
        "final_norm": 1.0 + nrm(ks[16], (D,), 0.05),
    }


def reference(x, c, norm_ffn1, norm_mix, norm_ffn2, w_ada, b_ada, w_ffn1_in, w_ffn1_out,
              w_ffn2_in, w_ffn2_out, conv_in, conv_w, conv_out, pool_w, pool_scale, final_norm):
    c_act = jax.nn.silu(c)
    for i in range(DEPTH):
        mods = jnp.einsum('bd,de->be', c_act, w_ada[i]) + b_ada[i]
        sh1, sc1, g1, sh2, sc2, g2, sh3, sc3, g3 = jnp.split(mods, N_MOD, axis=-1)

        h = modulate(rmsnorm(x, norm_ffn1[i]), sh1, sc1)
        x = x + FFN_RES_WEIGHT * g1[:, None, :] * swiglu(h, w_ffn1_in[i], w_ffn1_out[i])

        h = modulate(rmsnorm(x, norm_mix[i]), sh2, sc2)
        j = i // N_MIXERS
        if i % N_MIXERS == 0:
            m = short_conv_mixer(h, conv_in[j], conv_w[j], conv_out[j])
        else:
            m = pooling_mixer(h, pool_w[j], pool_scale[j])
        x = x + g2[:, None, :] * m

        h = modulate(rmsnorm(x, norm_ffn2[i]), sh3, sc3)
        x = x + FFN_RES_WEIGHT * g3[:, None, :] * swiglu(h, w_ffn2_in[i], w_ffn2_out[i])
    return rmsnorm(x, final_norm)
```

```cpp
#include <hip/hip_runtime.h>
#include <cstdio>
#include <cstdint>

#ifndef MK_PER_PHASE
#define MK_PER_PHASE 1
#endif

#define LAS __attribute__((address_space(3)))
#define GAS __attribute__((address_space(1)))
typedef unsigned short bf16_t;
typedef short bf16x8 __attribute__((ext_vector_type(8)));
typedef float f32x4 __attribute__((ext_vector_type(4)));
typedef float f32x2 __attribute__((ext_vector_type(2)));
typedef unsigned u32x4 __attribute__((ext_vector_type(4)));
typedef unsigned u32x2 __attribute__((ext_vector_type(2)));

constexpr int D = 2048, NB = 4, SEQ = 4096, M = NB * SEQ, F = 5632, DEPTH = 4, NMOD = 9, MODS_LD = NMOD * D;
constexpr int NSB = 3 * DEPTH;
constexpr float EPS = 1e-6f;
constexpr float INV_D = 1.0f / (float)D;

constexpr size_t MiB = 1u << 20;
constexpr size_t WS_CTL = 0;
constexpr size_t WS_MODS = 64 * 1024;
constexpr size_t MODS_BYTES = (size_t)DEPTH * NB * MODS_LD * 4;
constexpr size_t WS_ROWSS = WS_MODS + MODS_BYTES;
constexpr size_t ROWSS_BYTES = (size_t)(NSB + 1) * M * 4;
constexpr size_t ZERO_BYTES = ((WS_ROWSS + ROWSS_BYTES + 4095) / 4096) * 4096;
constexpr size_t WS_BIAS_IN = 4 * MiB;
constexpr size_t WS_BIAS_CV = WS_BIAS_IN + (size_t)8 * NB * 2 * F * 4;
constexpr size_t WS_WIN = 8 * MiB;
constexpr size_t WIN_BYTES = (size_t)2 * F * D * 2;
constexpr size_t WS_WOUT = WS_WIN + 8 * WIN_BYTES;
constexpr size_t WOUT_BYTES = (size_t)D * F * 2;
constexpr size_t WS_WCVI = WS_WOUT + 8 * WOUT_BYTES;
constexpr size_t WCVI_BYTES = (size_t)3 * D * D * 2;
constexpr size_t WS_WCVO = WS_WCVI + 2 * WCVI_BYTES;
constexpr size_t WCVO_BYTES = (size_t)D * D * 2;
constexpr size_t WS_WPOOL = WS_WCVO + 2 * WCVO_BYTES;
constexpr size_t WPOOL_BYTES = (size_t)D * 512 * 2;
constexpr size_t WS_X = WS_WPOOL + 2 * WPOOL_BYTES;
constexpr size_t WS_XA = WS_X + (size_t)M * D * 4;
constexpr size_t WS_HID = WS_XA + (size_t)M * D * 2;
constexpr size_t WS_U = WS_HID + (size_t)M * F * 2;
constexpr size_t WS_BG = WS_U + (size_t)M * D * 2;
constexpr size_t WS_ZA = WS_BG + (size_t)M * D * 2;
constexpr size_t WS_END = WS_ZA + (size_t)M * D * 2;
static_assert(ZERO_BYTES <= WS_BIAS_IN && WS_BIAS_CV + (size_t)2 * NB * 3 * D * 4 <= WS_WIN, "d_ws map");

constexpr int RING_BYTES = 131072;
constexpr int LDS_MISC = RING_BYTES;
constexpr int LDS_BYTES = 147456;

#define LDS_WAIT() asm volatile("s_waitcnt lgkmcnt(0)" ::: "memory")
#define VM_WAIT() asm volatile("s_waitcnt vmcnt(0)" ::: "memory")

__device__ __forceinline__ unsigned cvt_pk_bf16(float lo, float hi) { unsigned r; asm volatile("v_cvt_pk_bf16_f32 %0, %1, %2" : "=v"(r) : "v"(lo), "v"(hi)); return r; }
__device__ __forceinline__ float bf_lo(unsigned w) { return __uint_as_float(w << 16); }
__device__ __forceinline__ float bf_hi(unsigned w) { return __uint_as_float(w & 0xffff0000u); }
__device__ __forceinline__ float wave_sum(float v) {
#pragma unroll
    for (int o = 1; o < 64; o <<= 1) v += __shfl_xor(v, o);
    return v;
}
__device__ __forceinline__ void atomic_add_f32(float* p, float v) { unsafeAtomicAdd(p, v); }
__device__ __forceinline__ int opaque_v(int v) { asm volatile("" : "+v"(v)); return v; }
__device__ __forceinline__ int opaque_s(int v) { asm volatile("" : "+s"(v)); return v; }
template <class T> __device__ __forceinline__ T* opaque_p(T* p) { asm volatile("" : "+s"(p)); return p; }

namespace pg8 {
constexpr int BM = 256, BK = 64, HALF = 128, HTB = HALF * BK * 2, STAGE_BYTES = 8 * HTB, NXCD = 8, WGM = 8;
__host__ __device__ __forceinline__ int lds_byte(int r, int c) { const int st = (r >> 4) * 2 + (c >> 5), rr = r & 15, cc = c & 31, ob = rr * 64 + cc * 2; return st * 1024 + (ob ^ (((ob >> 9) & 1) << 5)); }
__host__ __device__ __forceinline__ void stage_rc(int b, int& R, int& C) { const int st = b / 1024, sb = b % 1024, swz = sb ^ (((sb >> 9) & 1) << 5); R = (st >> 1) * 16 + swz / 64; C = (st & 1) * 32 + (swz % 64) / 2; }
__host__ __device__ __forceinline__ int perm32(int rho) { const int n = rho >> 4, i = rho & 15; return 8 * (i >> 2) + 4 * n + (i & 3); }

struct Unit { int pm, pn; };
struct Gemm { const bf16_t* A; const bf16_t* Bt; int M, N, K, lda, gt; };

struct StaticOrder {
    int nM, nN, nwg, G, c;
    __device__ void init(int M_, int N_, int G_, int c_) { nM = M_ / BM; nN = N_ / BM; nwg = nM * nN; G = G_; c = c_; }
    __device__ bool next(int i, Unit& u) const {
        const long L = (long)i * G + c; if (L >= nwg) return false;
        int wgid = (int)L; { const int q = nwg / NXCD, r = nwg % NXCD, xcd = wgid % NXCD, off = wgid / NXCD; wgid = (xcd < r ? xcd * (q + 1) : r * (q + 1) + (xcd - r) * q) + off; }
        const int nig = WGM * nN, gid = wgid / nig, fm = gid * WGM, gsz = (nM - fm) < WGM ? (nM - fm) : WGM;
        u.pm = fm + ((wgid % nig) % gsz); u.pn = (wgid % nig) / gsz; return true;
    }
};

__device__ __forceinline__ f32x4 silu4(f32x4 v) {
    f32x4 o;
#pragma unroll
    for (int i = 0; i < 4; ++i) { const float e = __builtin_amdgcn_exp2f(v[i] * -1.4426950408889634f); o[i] = v[i] * __builtin_amdgcn_rcpf(1.0f + e); }
    return o;
}
struct EpiGate {
    static constexpr bool PERM = true;
    bf16_t* outP; bf16_t* outS; const float* rowss; const float* bias; int ldP, ldS, npair, act, nbias;
    __device__ __forceinline__ void operator()(const f32x4 (&acc)[2][2][4][2], const Unit& u, int wr, int wc, int fr, int fq) const {
        const int row0 = u.pm * BM + wr * 64 + fr, b = u.pm >> 4;
        const GAS float* bp = (const GAS float*)bias + (size_t)b * nbias + u.pn * BM + wc * 32 + 8 * fq;
        const GAS float* rp = (const GAS float*)rowss + row0;
        f32x4 bv[2][2]; float rs[2][4];
#pragma unroll
        for (int bj = 0; bj < 2; ++bj)
#pragma unroll
            for (int n = 0; n < 2; ++n) bv[bj][n] = *(const GAS f32x4*)(bp + bj * HALF + 4 * n);
#pragma unroll
        for (int ai = 0; ai < 2; ++ai)
#pragma unroll
            for (int m = 0; m < 4; ++m) rs[ai][m] = rp[ai * HALF + m * 16];
#pragma unroll
        for (int ai = 0; ai < 2; ++ai)
#pragma unroll
            for (int m = 0; m < 4; ++m) rs[ai][m] = __builtin_amdgcn_rsqf(rs[ai][m] * INV_D + EPS);
        const bool paired = u.pn < npair;
        GAS bf16_t* ob = paired ? (GAS bf16_t*)outP + (u.pn * HALF + wc * 32 + 8 * fq) : (GAS bf16_t*)outS + ((u.pn - npair) * BM + wc * 32 + 8 * fq);
        const int ldo = paired ? ldP : ldS;
        if (paired) {
#pragma unroll
            for (int ai = 0; ai < 2; ++ai)
#pragma unroll
                for (int m = 0; m < 4; ++m) {
                    const int row = row0 + ai * HALF + m * 16; const float r = rs[ai][m];
                    const f32x4 g0 = acc[ai][0][m][0] * r + bv[0][0], g1 = acc[ai][0][m][1] * r + bv[0][1];
                    const f32x4 u0 = acc[ai][1][m][0] * r + bv[1][0], u1 = acc[ai][1][m][1] * r + bv[1][1];
                    f32x4 o0, o1;
                    if (act) { o0 = silu4(g0) * u0; o1 = silu4(g1) * u1; } else { o0 = g0 * u0; o1 = g1 * u1; }
                    u32x4 w; w.x = cvt_pk_bf16(o0[0], o0[1]); w.y = cvt_pk_bf16(o0[2], o0[3]); w.z = cvt_pk_bf16(o1[0], o1[1]); w.w = cvt_pk_bf16(o1[2], o1[3]);
                    *(GAS u32x4*)(ob + (size_t)row * ldo) = w;
                }
        } else {
#pragma unroll
            for (int ai = 0; ai < 2; ++ai)
#pragma unroll
                for (int m = 0; m < 4; ++m) {
                    const int row = row0 + ai * HALF + m * 16; const float r = rs[ai][m];
                    const f32x4 g0 = acc[ai][0][m][0] * r + bv[0][0], g1 = acc[ai][0][m][1] * r + bv[0][1];
                    const f32x4 u0 = acc[ai][1][m][0] * r + bv[1][0], u1 = acc[ai][1][m][1] * r + bv[1][1];
                    GAS bf16_t* op = ob + (size_t)row * ldo;
                    u32x4 w; w.x = cvt_pk_bf16(g0[0], g0[1]); w.y = cvt_pk_bf16(g0[2], g0[3]); w.z = cvt_pk_bf16(g1[0], g1[1]); w.w = cvt_pk_bf16(g1[2], g1[3]);
                    *(GAS u32x4*)op = w;
                    u32x4 v; v.x = cvt_pk_bf16(u0[0], u0[1]); v.y = cvt_pk_bf16(u0[2], u0[3]); v.z = cvt_pk_bf16(u1[0], u1[1]); v.w = cvt_pk_bf16(u1[2], u1[3]);
                    *(GAS u32x4*)(op + HALF) = v;
                }
        }
    }
};
struct EpiRes {
    static constexpr bool PERM = false;
    const float* xin; float* xout; bf16_t* xa; float* rowss_next; const float* gate; const float* pscale; const float* gain_next; const float* scale_next; float coef;
    __device__ __forceinline__ void operator()(const f32x4 (&acc)[2][2][4][2], const Unit& u, int wr, int wc, int fr, int fq) const {
        const int row0 = u.pm * BM + wr * 64 + fr, b = u.pm >> 4, col0 = u.pn * BM + wc * 32 + 4 * fq;
        const GAS float* gp = (const GAS float*)gate + (size_t)b * MODS_LD + col0;
        const GAS float* sp = (const GAS float*)scale_next + (size_t)b * MODS_LD + col0;
        const GAS float* np = (const GAS float*)gain_next + col0;
        const GAS float* pp = (const GAS float*)pscale + col0;
        const bool has_xa = xa != nullptr, has_ps = pscale != nullptr;
        f32x4 gv[2][2], av[2][2];
#pragma unroll
        for (int bj = 0; bj < 2; ++bj)
#pragma unroll
            for (int n = 0; n < 2; ++n) {
                const int c = bj * HALF + n * 16;
                f32x4 g = *(const GAS f32x4*)(gp + c) * coef;
                if (has_ps) g = g * *(const GAS f32x4*)(pp + c);
                gv[bj][n] = g;
                if (has_xa) av[bj][n] = *(const GAS f32x4*)(np + c) * (*(const GAS f32x4*)(sp + c) + 1.0f);
                else av[bj][n] = (f32x4){0.f, 0.f, 0.f, 0.f};
            }
        const GAS float* xi = (const GAS float*)xin + col0; GAS float* xo = (GAS float*)xout + col0; GAS bf16_t* xap = (GAS bf16_t*)xa + col0;
        GAS float* rn = (GAS float*)rowss_next;
#pragma unroll
        for (int ai = 0; ai < 2; ++ai)
#pragma unroll
            for (int m = 0; m < 4; ++m) {
                const int row = row0 + ai * HALF + m * 16;
                const size_t off = (size_t)row * D;
                f32x4 xr[2][2];
#pragma unroll
                for (int bj = 0; bj < 2; ++bj)
#pragma unroll
                    for (int n = 0; n < 2; ++n) xr[bj][n] = *(const GAS f32x4*)(xi + off + bj * HALF + n * 16);
                float ss = 0.f;
#pragma unroll
                for (int bj = 0; bj < 2; ++bj)
#pragma unroll
                    for (int n = 0; n < 2; ++n) {
                        const f32x4 v = xr[bj][n] + gv[bj][n] * acc[ai][bj][m][n];
                        *(GAS f32x4*)(xo + off + bj * HALF + n * 16) = v;
                        ss += (v[0] * v[0] + v[1] * v[1]) + (v[2] * v[2] + v[3] * v[3]);
                        if (has_xa) { const f32x4 o = v * av[bj][n]; u32x2 w; w.x = cvt_pk_bf16(o[0], o[1]); w.y = cvt_pk_bf16(o[2], o[3]); *(GAS u32x2*)(xap + off + bj * HALF + n * 16) = w; }
                    }
                ss += __shfl_xor(ss, 16); ss += __shfl_xor(ss, 32);
                if (fq == 0) atomic_add_f32((float*)(rn + row), ss);
                if (m & 1) asm volatile("" ::: "memory");
            }
    }
};

template <class Epi, bool ALIGN_EPI, bool SP2>
__device__ __forceinline__ void gemm_phase(LAS unsigned char* lds, const Gemm g, const StaticOrder S, const Epi E) {
    const int tid = opaque_v((int)threadIdx.x), wid = __builtin_amdgcn_readfirstlane(tid >> 6), lane = tid & 63, wr = wid >> 2, wc = wid & 3, fr = lane & 15, fq = lane >> 4;
    const int K = g.K, nt = K / BK;
    unsigned voffA[2], voffB[2];
#pragma unroll
    for (int i = 0; i < 2; ++i) { int R, C; stage_rc(tid * 16 + i * 8192, R, C); const int Rb = Epi::PERM ? ((R & ~31) + perm32(R & 31)) : R;
        voffA[i] = (unsigned)(R * g.lda + C) * 2u; voffB[i] = (unsigned)(Rb * K + C) * 2u; }
    const size_t kstep = (size_t)(BK * 2);
    const size_t hA = (size_t)HALF * g.lda * 2, tA = 2 * hA;
    const size_t hB = (size_t)HALF * K * 2, tB = 2 * hB;
    const unsigned ldsw = (unsigned)wid * 1024u;
    const int aoff = lds_byte(wr * 64 + fr, fq * 8), boff = lds_byte(wc * 32 + fr, fq * 8);
#define PG8_SA(b, h) (((b) * 2 + (h)) * HTB)
#define PG8_SB(b, h) ((4 + (b) * 2 + (h)) * HTB)
#define PG8_STAGE(bufoff, gbase, voff) do { _Pragma("unroll") for (int _i = 0; _i < 2; ++_i) \
        __builtin_amdgcn_global_load_lds((const unsigned*)((const char*)(gbase) + (voff)[_i]), (LAS unsigned*)(lds + (bufoff) + ldsw + _i * 8192), 16, 0, 0); } while (0)
#define PG8_LDA(dst, b, h) do { _Pragma("unroll") for (int m = 0; m < 4; ++m) _Pragma("unroll") for (int k = 0; k < 2; ++k) dst[m][k] = *(const LAS bf16x8*)(lds + PG8_SA(b, h) + aoff + m * 2048 + k * 1024); } while (0)
#define PG8_LDB(dst, b, h) do { _Pragma("unroll") for (int n = 0; n < 2; ++n) _Pragma("unroll") for (int k = 0; k < 2; ++k) dst[n][k] = *(const LAS bf16x8*)(lds + PG8_SB(b, h) + boff + n * 2048 + k * 1024); } while (0)
#define PG8_MMA(ai, bj, At, Bt) do { __builtin_amdgcn_s_setprio(1); _Pragma("unroll") for (int m = 0; m < 4; ++m) _Pragma("unroll") for (int n = 0; n < 2; ++n) _Pragma("unroll") for (int k = 0; k < 2; ++k) \
        acc[ai][bj][m][n] = __builtin_amdgcn_mfma_f32_16x16x32_bf16(Bt[n][k], At[m][k], acc[ai][bj][m][n], 0, 0, 0); __builtin_amdgcn_s_setprio(0); } while (0)
#define PG8_WAIT_V(n) asm volatile("s_waitcnt vmcnt(" #n ")" ::: "memory")
#define PG8_WAIT_L(n) asm volatile("s_waitcnt lgkmcnt(" #n ")" ::: "memory")
#define PG8_BAR __builtin_amdgcn_s_barrier()
#define PG8_SCHED __builtin_amdgcn_sched_barrier(0)
    Unit cur, nxt; int ui = 0;
    if (!S.next(0, cur)) return;
    f32x4 acc[2][2][4][2];
#pragma unroll
    for (int a = 0; a < 2; ++a)
#pragma unroll
        for (int b = 0; b < 2; ++b)
#pragma unroll
            for (int m = 0; m < 4; ++m)
#pragma unroll
                for (int n = 0; n < 2; ++n) acc[a][b][m][n] = (f32x4){0.f, 0.f, 0.f, 0.f};
    bf16x8 At[4][2], B0[2][2], B1[2][2];
    const size_t gK2 = (size_t)K * 2;
    const char* cA = (const char*)g.A + (size_t)cur.pm * tA + (g.gt ? (size_t)(cur.pn / g.gt) * gK2 : 0); const char* cB = (const char*)g.Bt + (size_t)cur.pn * tB;
    if constexpr (SP2) {
        PG8_STAGE(PG8_SB(0, 0), cB, voffB); PG8_STAGE(PG8_SB(0, 1), cB + hB, voffB); PG8_STAGE(PG8_SA(0, 0), cA, voffA); PG8_STAGE(PG8_SA(0, 1), cA + hA, voffA);
        if (wr == 1) PG8_BAR;
        PG8_WAIT_V(2); PG8_BAR;
        PG8_STAGE(PG8_SB(1, 0), cB + kstep, voffB); PG8_STAGE(PG8_SA(1, 0), cA + kstep, voffA); PG8_STAGE(PG8_SB(1, 1), cB + hB + kstep, voffB);
        PG8_WAIT_V(6); PG8_BAR;
    } else {
        PG8_STAGE(PG8_SB(0, 0), cB, voffB); PG8_STAGE(PG8_SA(0, 0), cA, voffA); PG8_STAGE(PG8_SB(0, 1), cB + hB, voffB); PG8_STAGE(PG8_SA(0, 1), cA + hA, voffA);
        if (wr == 1) PG8_BAR;
        PG8_WAIT_V(4); PG8_BAR;
        PG8_STAGE(PG8_SB(1, 0), cB + kstep, voffB); PG8_STAGE(PG8_SA(1, 0), cA + kstep, voffA); PG8_STAGE(PG8_SB(1, 1), cB + hB + kstep, voffB);
        PG8_WAIT_V(6); PG8_BAR;
    }
    for (;;) {
        const bool has_next = S.next(ui + 1, nxt);
        const char* nA = has_next ? (const char*)g.A + (size_t)nxt.pm * tA + (g.gt ? (size_t)(nxt.pn / g.gt) * gK2 : 0) : cA; const char* nB = has_next ? (const char*)g.Bt + (size_t)nxt.pn * tB : cB;
        for (int t = 0; t < nt; t += 2) {
            const bool last = (t == nt - 2);
            const char* a1 = cA + (size_t)(t + 1) * kstep;
            const char* a2 = last ? nA : cA + (size_t)(t + 2) * kstep; const char* b2 = last ? nB : cB + (size_t)(t + 2) * kstep;
            const char* a3 = a2 + kstep; const char* b3 = b2 + kstep;
            if constexpr (SP2) {
            PG8_LDB(B0, 0, 0); PG8_LDB(B1, 0, 1); PG8_SCHED; PG8_LDA(At, 0, 0); PG8_STAGE(PG8_SA(1, 1), a1 + hA, voffA);
            PG8_WAIT_V(8); PG8_WAIT_L(0); PG8_BAR; PG8_MMA(0, 0, At, B0); PG8_MMA(0, 1, At, B1); PG8_BAR; PG8_SCHED;
            PG8_LDA(At, 0, 1); PG8_STAGE(PG8_SB(0, 0), b2, voffB); PG8_STAGE(PG8_SB(0, 1), b2 + hB, voffB); PG8_STAGE(PG8_SA(0, 0), a2, voffA);
            PG8_WAIT_V(8); PG8_WAIT_L(0); PG8_BAR; PG8_MMA(1, 0, At, B0); PG8_MMA(1, 1, At, B1); PG8_BAR; PG8_SCHED;
            PG8_LDB(B0, 1, 0); PG8_LDB(B1, 1, 1); PG8_SCHED; PG8_LDA(At, 1, 0); PG8_STAGE(PG8_SA(0, 1), a2 + hA, voffA);
            PG8_WAIT_V(8); PG8_WAIT_L(0); PG8_BAR; PG8_MMA(0, 0, At, B0); PG8_MMA(0, 1, At, B1); PG8_BAR; PG8_SCHED;
            PG8_LDA(At, 1, 1); PG8_STAGE(PG8_SB(1, 0), b3, voffB); PG8_STAGE(PG8_SB(1, 1), b3 + hB, voffB); PG8_STAGE(PG8_SA(1, 0), a3, voffA);
            PG8_WAIT_V(8); PG8_WAIT_L(0); PG8_BAR; PG8_MMA(1, 0, At, B0); PG8_MMA(1, 1, At, B1); PG8_BAR; PG8_SCHED;
            } else {
            PG8_LDB(B0, 0, 0); PG8_SCHED; PG8_LDA(At, 0, 0); PG8_STAGE(PG8_SA(1, 1), a1 + hA, voffA);
            PG8_WAIT_L(8); PG8_BAR; PG8_WAIT_L(0); PG8_MMA(0, 0, At, B0); PG8_BAR; PG8_SCHED;
            PG8_LDB(B1, 0, 1); PG8_STAGE(PG8_SB(0, 0), b2, voffB);
            PG8_BAR; PG8_WAIT_L(0); PG8_MMA(0, 1, At, B1); PG8_BAR;
            PG8_LDA(At, 0, 1); PG8_STAGE(PG8_SA(0, 0), a2, voffA);
            PG8_BAR; PG8_WAIT_L(0); PG8_MMA(1, 0, At, B0); PG8_BAR; PG8_SCHED;
            PG8_STAGE(PG8_SB(0, 1), b2 + hB, voffB);
            PG8_WAIT_V(6); PG8_BAR; PG8_MMA(1, 1, At, B1); PG8_BAR;
            PG8_LDB(B0, 1, 0); PG8_SCHED; PG8_LDA(At, 1, 0); PG8_STAGE(PG8_SA(0, 1), a2 + hA, voffA);
            PG8_WAIT_L(8); PG8_BAR; PG8_WAIT_L(0); PG8_MMA(0, 0, At, B0); PG8_BAR; PG8_SCHED;
            PG8_LDB(B1, 1, 1); PG8_STAGE(PG8_SB(1, 0), b3, voffB);
            PG8_BAR; PG8_WAIT_L(0); PG8_MMA(0, 1, At, B1); PG8_BAR;
            PG8_LDA(At, 1, 1); PG8_STAGE(PG8_SA(1, 0), a3, voffA);
            PG8_BAR; PG8_WAIT_L(0); PG8_MMA(1, 0, At, B0); PG8_BAR; PG8_SCHED;
            PG8_STAGE(PG8_SB(1, 1), b3 + hB, voffB);
            PG8_WAIT_V(6); PG8_BAR; PG8_MMA(1, 1, At, B1); PG8_BAR;
            }
        }
        if constexpr (ALIGN_EPI) { if (wr == 0) PG8_BAR; }
        E(acc, cur, wr, wc, fr, fq);
        if (!has_next) break;
#pragma unroll
        for (int a = 0; a < 2; ++a)
#pragma unroll
            for (int b = 0; b < 2; ++b)
#pragma unroll
                for (int m = 0; m < 4; ++m)
#pragma unroll
                    for (int n = 0; n < 2; ++n) acc[a][b][m][n] = (f32x4){0.f, 0.f, 0.f, 0.f};
        cur = nxt; cA = nA; cB = nB; ++ui;
        if constexpr (ALIGN_EPI) { if (wr == 1) PG8_BAR; }
    }
    PG8_WAIT_V(0);
    if constexpr (!ALIGN_EPI) { if (wr == 0) PG8_BAR; }
    PG8_BAR;
#undef PG8_SA
#undef PG8_SB
#undef PG8_STAGE
#undef PG8_LDA
#undef PG8_LDB
#undef PG8_MMA
#undef PG8_WAIT_V
#undef PG8_WAIT_L
#undef PG8_BAR
#undef PG8_SCHED
}
}

#define XB_TMO      128
#define XB_XCNT(j)  (256  + 64 * (j))
#define XB_XSUB(j)  (1280 + 64 * (j))
#define XB_XGEN(j)  (2304 + 64 * (j))
#define XB_TOP      3328
#define XB_TOPGEN   3392
#define XCD_BAR_WORDS 3456
#define XB_SPIN_CAP (1u << 18)
static_assert(XCD_BAR_WORDS * 4 <= WS_MODS, "barrier words inside the control region");

__device__ __forceinline__ unsigned xb_ld(unsigned* p)              { return __hip_atomic_load(p, __ATOMIC_RELAXED, __HIP_MEMORY_SCOPE_AGENT); }
__device__ __forceinline__ unsigned xb_add(unsigned* p, unsigned v) { return __hip_atomic_fetch_add(p, v, __ATOMIC_RELAXED, __HIP_MEMORY_SCOPE_AGENT); }
__device__ __forceinline__ unsigned xb_xcc_id() { return (unsigned)__builtin_amdgcn_s_getreg((3 << 11) | 20) & 0xFu; }
#define XB_SPIN(cond, bar) do { unsigned _sp = 0; while (cond) { __builtin_amdgcn_s_sleep(1); \
    if ((++_sp & 255u) == 0u) { if (xb_ld(&(bar)[XB_TMO])) break; if (_sp > XB_SPIN_CAP) { atomicAdd(&(bar)[XB_TMO], 1u); break; } } } } while (0)

struct XcdBarrier { unsigned* bar; unsigned x; volatile LAS unsigned* st; };

__device__ __forceinline__ XcdBarrier xcd_barrier_post(unsigned* bar, volatile LAS unsigned* st) {
    XcdBarrier b; b.bar = bar; b.x = xb_xcc_id(); b.st = st;
    if (threadIdx.x == 0) (void)xb_add(&bar[XB_XCNT(b.x)], 1u);
    return b;
}
__device__ __forceinline__ void xcd_barrier_complete(unsigned* bar, unsigned x, unsigned& nloc, unsigned& nx) {
    const unsigned G = gridDim.x * gridDim.y * gridDim.z;
    unsigned sum, cnt, mine, sp = 0u;
    for (;;) {
        sum = 0u; cnt = 0u; mine = 0u;
#pragma unroll
        for (unsigned j = 0; j < 16; ++j) { const unsigned c = xb_ld(&bar[XB_XCNT(j)]); sum += c; cnt += (c > 0u) ? 1u : 0u; mine = (j == x) ? c : mine; }
        if (sum == G) break;
        __builtin_amdgcn_s_sleep(1);
        if ((++sp & 255u) == 0u) { if (xb_ld(&bar[XB_TMO])) break; if (sp > XB_SPIN_CAP) { atomicAdd(&bar[XB_TMO], 1u); break; } }
    }
    nloc = mine > 0u ? mine : 1u; nx = cnt > 0u ? cnt : 1u;
}
__device__ __forceinline__ void xcd_barrier(const XcdBarrier& b) {
    asm volatile("s_waitcnt vmcnt(0)" ::: "memory");
    __syncthreads();
    if (threadIdx.x == 0) {
        unsigned* bar = b.bar;
        __builtin_amdgcn_s_waitcnt(0);
        unsigned nloc = b.st[0], nx = b.st[1];
        unsigned bx = b.x; asm volatile("" : "+s"(bx));
        if (nloc == 0u) { xcd_barrier_complete(bar, bx, nloc, nx); b.st[0] = nloc; b.st[1] = nx; }
        const unsigned old = xb_add(&bar[XB_XSUB(bx)], 1u);
        const unsigned gen = old / nloc;
        if (old + 1u == (gen + 1u) * nloc) {
            __builtin_amdgcn_fence(__ATOMIC_RELEASE, "agent");
            asm volatile("s_waitcnt vmcnt(0)" ::: "memory");
            const unsigned og = xb_add(&bar[XB_TOP], 1u);
            const unsigned tg = og / nx;
            if (og + 1u == (tg + 1u) * nx) xb_add(&bar[XB_TOPGEN], 1u);
            else XB_SPIN(xb_ld(&bar[XB_TOPGEN]) == tg, bar);
            __builtin_amdgcn_fence(__ATOMIC_ACQUIRE, "agent");
            xb_add(&bar[XB_XGEN(bx)], 1u);
            asm volatile("s_waitcnt vmcnt(0)" ::: "memory");
        } else {
            XB_SPIN(xb_ld(&bar[XB_XGEN(bx)]) == gen, bar);
            __builtin_amdgcn_fence(__ATOMIC_ACQUIRE, "agent");
            asm volatile("s_waitcnt vmcnt(0)" ::: "memory");
        }
    }
    __syncthreads();
}

__device__ __forceinline__ void phase_mods(LAS unsigned char* lds, const float* c, const float* w_ada, const float* b_ada, float* mods, int wg, int G) {
    const int tid = opaque_v((int)threadIdx.x), wave = __builtin_amdgcn_readfirstlane(tid >> 6), lane = tid & 63;
    LAS float* cact = (LAS float*)lds;
    LAS float* red = (LAS float*)(lds + 32768);
    for (int i = tid; i < NB * D; i += 512) { const float v = c[i]; cact[i] = v / (1.0f + __expf(-v)); }
    __syncthreads();
    constexpr int NCH = MODS_LD / 256;
    for (int it = wg; it < DEPTH * NCH * 8; it += G) {
        const int k8 = it & 7, rest = it >> 3, nc = rest % NCH, l = rest / NCH;
        const int kb = k8 * 256 + wave * 32;
        const float* wp = w_ada + ((size_t)l * D + kb) * MODS_LD + nc * 256 + lane * 4;
        f32x4 a0 = {0.f, 0.f, 0.f, 0.f}, a1 = a0, a2 = a0, a3 = a0;
#pragma unroll 8
        for (int i = 0; i < 32; ++i) {
            const f32x4 v = *(const f32x4*)(wp + (size_t)i * MODS_LD);
            a0 += v * cact[kb + i]; a1 += v * cact[D + kb + i]; a2 += v * cact[2 * D + kb + i]; a3 += v * cact[3 * D + kb + i];
        }
#pragma unroll
        for (int j = 0; j < 4; ++j) { red[(wave * 16 + 0 + j) * 64 + lane] = a0[j]; red[(wave * 16 + 4 + j) * 64 + lane] = a1[j]; red[(wave * 16 + 8 + j) * 64 + lane] = a2[j]; red[(wave * 16 + 12 + j) * 64 + lane] = a3[j]; }
        __syncthreads();
        {
            const int b = tid >> 7;
#pragma unroll
            for (int h = 0; h < 2; ++h) {
                const int col = (tid & 127) + 128 * h;
                float s = 0.f;
#pragma unroll
                for (int w = 0; w < 8; ++w) s += red[(w * 16 + b * 4 + (col & 3)) * 64 + (col >> 2)];
                if (k8 == 0) s += b_ada[(size_t)l * MODS_LD + nc * 256 + col];
                atomic_add_f32(mods + ((size_t)l * NB + b) * MODS_LD + nc * 256 + col, s);
            }
        }
        __syncthreads();
    }
}

struct TItem { const float* src; bf16_t* dst; int K, N, n0, row0; float* bias; int nbias; const float* shift; };
__device__ __forceinline__ void transpose_item(LAS unsigned char* lds, const TItem& it) {
    const int tid = opaque_v((int)threadIdx.x), wave = __builtin_amdgcn_readfirstlane(tid >> 6), lane = tid & 63;
    LAS float* scr = (LAS float*)(lds + wave * 8448);
    LAS float* shl = (LAS float*)(lds + 67584);
    LAS float* red = (LAS float*)(lds + 67584 + 32768);
    const bool hb = it.bias != nullptr;
    if (hb) {
        for (int i = tid; i < NB * D; i += 512) shl[i] = it.shift[(size_t)(i >> 11) * MODS_LD + (i & 2047)];
        __syncthreads();
    }
    const int kk = lane >> 3, q = lane & 7;
    const int Kw = it.K >> 3, nsub = Kw >> 6;
    f32x4 s0 = {0.f, 0.f, 0.f, 0.f}, s1 = s0, s2 = s0, s3 = s0;
    for (int sub = 0; sub < nsub; ++sub) {
        const int k0 = wave * Kw + sub * 64;
        f32x4 w[8];
#pragma unroll
        for (int i = 0; i < 8; ++i) w[i] = *(const f32x4*)(it.src + (size_t)(k0 + kk + 8 * i) * it.N + it.n0 + 4 * q);
        if (hb) {
#pragma unroll
            for (int i = 0; i < 8; ++i) { const int k = k0 + kk + 8 * i; s0 += w[i] * shl[k]; s1 += w[i] * shl[D + k]; s2 += w[i] * shl[2 * D + k]; s3 += w[i] * shl[3 * D + k]; }
        }
#pragma unroll
        for (int i = 0; i < 8; ++i)
#pragma unroll
            for (int j = 0; j < 4; ++j) scr[(kk + 8 * i) * 33 + 4 * q + j] = w[i][j];
        LDS_WAIT();
        const int c = lane & 7;
#pragma unroll
        for (int j = 0; j < 4; ++j) {
            const int n = (lane >> 3) + 8 * j; const LAS float* s = scr + (8 * c) * 33 + n;
            u32x4 o; o.x = cvt_pk_bf16(s[0 * 33], s[1 * 33]); o.y = cvt_pk_bf16(s[2 * 33], s[3 * 33]); o.z = cvt_pk_bf16(s[4 * 33], s[5 * 33]); o.w = cvt_pk_bf16(s[6 * 33], s[7 * 33]);
            *(u32x4*)(it.dst + (size_t)(it.row0 + n) * it.K + k0 + 8 * c) = o;
        }
        LDS_WAIT();
    }
    if (hb) {
#pragma unroll
        for (int o = 8; o < 64; o <<= 1)
#pragma unroll
            for (int j = 0; j < 4; ++j) { s0[j] += __shfl_xor(s0[j], o); s1[j] += __shfl_xor(s1[j], o); s2[j] += __shfl_xor(s2[j], o); s3[j] += __shfl_xor(s3[j], o); }
        if (lane < 8) {
#pragma unroll
            for (int j = 0; j < 4; ++j) { red[(wave * 4 + 0) * 32 + 4 * q + j] = s0[j]; red[(wave * 4 + 1) * 32 + 4 * q + j] = s1[j]; red[(wave * 4 + 2) * 32 + 4 * q + j] = s2[j]; red[(wave * 4 + 3) * 32 + 4 * q + j] = s3[j]; }
        }
        __syncthreads();
        if (tid < 128) {
            const int b = tid >> 5, n = tid & 31; float s = 0.f;
#pragma unroll
            for (int w = 0; w < 8; ++w) s += red[(w * 4 + b) * 32 + n];
            it.bias[(size_t)b * it.nbias + it.row0 + n] = s;
        }
        __syncthreads();
    }
}

struct Ptrs {
    const float *x, *c, *norm_ffn1, *norm_mix, *norm_ffn2, *w_ada, *b_ada, *w_ffn1_in, *w_ffn1_out, *w_ffn2_in, *w_ffn2_out, *conv_in, *conv_w, *conv_out, *pool_w, *pool_scale, *final_norm;
    float* out; unsigned char* ws;
};
__device__ __forceinline__ int pair_row(int j, int second) { return 256 * (j >> 7) + 128 * second + (j & 127); }

__device__ __forceinline__ void phase_weights(LAS unsigned char* lds, const Ptrs& P, int wg, int G) {
    const int tid = opaque_v((int)threadIdx.x), wave = __builtin_amdgcn_readfirstlane(tid >> 6), lane = tid & 63;
    unsigned char* ws = P.ws;
    const float* mods = (const float*)(ws + WS_MODS);
    {
        float* rowss0 = (float*)(ws + WS_ROWSS);
        bf16_t* xa = (bf16_t*)(ws + WS_XA);
        const int gw = wg * 8 + wave, NGW = G * 8;
        for (int r = gw; r < M; r += NGW) {
            const int b = r >> 12;
            const f32x4* xr = (const f32x4*)(P.x + (size_t)r * D) + lane;
            f32x4 v[8]; float ss = 0.f;
#pragma unroll
            for (int j = 0; j < 8; ++j) { v[j] = xr[64 * j]; ss += (v[j][0] * v[j][0] + v[j][1] * v[j][1]) + (v[j][2] * v[j][2] + v[j][3] * v[j][3]); }
            ss = wave_sum(ss);
            if (lane == 0) rowss0[r] = ss;
#pragma unroll
            for (int j = 0; j < 8; ++j) {
                const int cidx = 4 * lane + 256 * j;
                const f32x4 a = *(const f32x4*)(P.norm_ffn1 + cidx) * (*(const f32x4*)(mods + (size_t)b * MODS_LD + D + cidx) + 1.0f);
                const f32x4 o = v[j] * a; u32x2 w; w.x = cvt_pk_bf16(o[0], o[1]); w.y = cvt_pk_bf16(o[2], o[3]);
                *(u32x2*)(xa + (size_t)r * D + cidx) = w;
            }
        }
    }
    constexpr int I_OUT = 8 * 64, I_IN = 8 * 352, I_CVI = 2 * 192, I_CVO = 2 * 64, I_POOL = 8 * 16;
    constexpr int NITEMS = I_OUT + I_IN + I_CVI + I_CVO + I_POOL;
    for (int item = wg; item < NITEMS; item += G) {
        TItem t; int r = item;
        if (r < I_OUT) { const int mat = r >> 6, nb = r & 63, l = mat >> 1, s2 = mat & 1;
            t.src = (s2 ? P.w_ffn2_out : P.w_ffn1_out) + (size_t)l * F * D; t.dst = (bf16_t*)(ws + WS_WOUT + (size_t)mat * WOUT_BYTES); t.K = F; t.N = D; t.n0 = nb * 32; t.row0 = nb * 32; t.bias = nullptr; t.nbias = 0; t.shift = nullptr; }
        else if ((r -= I_OUT) < I_IN) { const int mat = r / 352, nb = r % 352, l = mat >> 1, s2 = mat & 1, n0 = nb * 32;
            t.src = (s2 ? P.w_ffn2_in : P.w_ffn1_in) + (size_t)l * D * 2 * F; t.dst = (bf16_t*)(ws + WS_WIN + (size_t)mat * WIN_BYTES); t.K = D; t.N = 2 * F; t.n0 = n0;
            t.row0 = n0 < F ? pair_row(n0, 0) : pair_row(n0 - F, 1);
            t.bias = (float*)(ws + WS_BIAS_IN) + (size_t)mat * NB * 2 * F; t.nbias = 2 * F; t.shift = mods + (size_t)l * NB * MODS_LD + (s2 ? 6 * D : 0); }
        else if ((r -= I_IN) < I_CVI) { const int j = r / 192, nb = r % 192, n0 = nb * 32;
            t.src = P.conv_in + (size_t)j * D * 3 * D; t.dst = (bf16_t*)(ws + WS_WCVI + (size_t)j * WCVI_BYTES); t.K = D; t.N = 3 * D; t.n0 = n0;
            t.row0 = n0 < D ? 2 * D + n0 : (n0 < 2 * D ? pair_row(n0 - D, 0) : pair_row(n0 - 2 * D, 1));
            t.bias = (float*)(ws + WS_BIAS_CV) + (size_t)j * NB * 3 * D; t.nbias = 3 * D; t.shift = mods + (size_t)(2 * j) * NB * MODS_LD + 3 * D; }
        else if ((r -= I_CVI) < I_CVO) { const int j = r >> 6, nb = r & 63;
            t.src = P.conv_out + (size_t)j * D * D; t.dst = (bf16_t*)(ws + WS_WCVO + (size_t)j * WCVO_BYTES); t.K = D; t.N = D; t.n0 = nb * 32; t.row0 = nb * 32; t.bias = nullptr; t.nbias = 0; t.shift = nullptr; }
        else { r -= I_CVO; const int jg = r >> 4, nb = r & 15, j = jg >> 2, gq = jg & 3;
            t.src = P.pool_w + (size_t)jg * 512 * 512; t.dst = (bf16_t*)(ws + WS_WPOOL + (size_t)j * WPOOL_BYTES); t.K = 512; t.N = 512; t.n0 = nb * 32; t.row0 = gq * 512 + nb * 32; t.bias = nullptr; t.nbias = 0; t.shift = nullptr; }
        transpose_item(lds, t);
    }
}

__device__ __forceinline__ void phase_conv(const bf16_t* U, const bf16_t* BG, bf16_t* Z, const float* cw, int wg, int G) {
    const int tid = opaque_v((int)threadIdx.x), cg = tid & 255, rh = tid >> 8, c0 = cg * 8;
    float w0[8], w1[8], w2[8];
#pragma unroll
    for (int i = 0; i < 8; ++i) { w0[i] = cw[c0 + i]; w1[i] = cw[D + c0 + i]; w2[i] = cw[2 * D + c0 + i]; }
    for (int unit = wg; unit < M / 32; unit += G) {
        const int r0 = unit * 32 + rh * 16, tseq = r0 & (SEQ - 1);
        float p1[8], p2[8];
        if (tseq >= 2) {
            const u32x4 a = *(const u32x4*)(U + (size_t)(r0 - 2) * D + c0), b = *(const u32x4*)(U + (size_t)(r0 - 1) * D + c0);
#pragma unroll
            for (int i = 0; i < 4; ++i) { p2[2 * i] = bf_lo(a[i]); p2[2 * i + 1] = bf_hi(a[i]); p1[2 * i] = bf_lo(b[i]); p1[2 * i + 1] = bf_hi(b[i]); }
        } else {
#pragma unroll
            for (int i = 0; i < 8; ++i) { p1[i] = 0.f; p2[i] = 0.f; }
        }
#pragma unroll 4
        for (int rr = 0; rr < 16; ++rr) {
            const size_t off = (size_t)(r0 + rr) * D + c0;
            const u32x4 uu = *(const u32x4*)(U + off), bb = *(const u32x4*)(BG + off);
            float cu[8], cb[8], z[8];
#pragma unroll
            for (int i = 0; i < 4; ++i) { cu[2 * i] = bf_lo(uu[i]); cu[2 * i + 1] = bf_hi(uu[i]); cb[2 * i] = bf_lo(bb[i]); cb[2 * i + 1] = bf_hi(bb[i]); }
#pragma unroll
            for (int i = 0; i < 8; ++i) { z[i] = cb[i] * (w2[i] * cu[i] + w1[i] * p1[i] + w0[i] * p2[i]); p2[i] = p1[i]; p1[i] = cu[i]; }
            u32x4 o; o.x = cvt_pk_bf16(z[0], z[1]); o.y = cvt_pk_bf16(z[2], z[3]); o.z = cvt_pk_bf16(z[4], z[5]); o.w = cvt_pk_bf16(z[6], z[7]);
            *(u32x4*)(Z + off) = o;
        }
    }
}

template <int W>
__device__ __forceinline__ void pool_rows(const float* X, const LAS float* rl, bf16_t* PA, int r0, int tseq0, f32x4 av, int c0) {
    f32x4 ring[W]; f32x4 S = {0.f, 0.f, 0.f, 0.f};
    ring[0] = S;
#pragma unroll
    for (int j = 1; j < W; ++j) {
        if (tseq0 - W + j >= 0) ring[j] = *(const f32x4*)(X + (size_t)(r0 - W + j) * D + c0) * rl[15 - W + j];
        else ring[j] = (f32x4){0.f, 0.f, 0.f, 0.f};
        S += ring[j];
    }
    for (int jb = 0; jb < 64 / W; ++jb) {
#pragma unroll
        for (int j = 0; j < W; ++j) {
            const int t = jb * W + j, row = r0 + t;
            const f32x4 v = *(const f32x4*)(X + (size_t)row * D + c0) * rl[15 + t];
            S += v - ring[j]; ring[j] = v;
            const int cnt = (tseq0 + t + 1) < W ? (tseq0 + t + 1) : W;
            const f32x4 p = (S * (1.0f / (float)cnt) - v) * av;
            u32x2 o; o.x = cvt_pk_bf16(p[0], p[1]); o.y = cvt_pk_bf16(p[2], p[3]);
            *(u32x2*)(PA + (size_t)row * D + c0) = o;
        }
    }
}
__device__ __forceinline__ void phase_pool(LAS unsigned char* lds, const float* X, const float* rowss, bf16_t* PA, const float* gain, const float* scale  , int wg, int G) {
    const int tid = opaque_v((int)threadIdx.x), wave = __builtin_amdgcn_readfirstlane(tid >> 6), c0 = tid * 4;
    LAS float* rl = (LAS float*)lds;
    for (int unit = wg; unit < M / 64; unit += G) {
        const int r0 = unit * 64, tseq0 = r0 & (SEQ - 1), b = r0 >> 12;
        __syncthreads();
        if (tid < 79) { const int row = r0 - 15 + tid; rl[tid] = row >= 0 ? __builtin_amdgcn_rsqf(rowss[row] * INV_D + EPS) : 0.f; }
        __syncthreads();
        const f32x4 av = *(const f32x4*)(gain + c0) * (*(const f32x4*)(scale + (size_t)b * MODS_LD + c0) + 1.0f);
        const int g = wave >> 1;
        if (g == 0) pool_rows<2>(X, rl, PA, r0, tseq0, av, c0);
        else if (g == 1) pool_rows<4>(X, rl, PA, r0, tseq0, av, c0);
        else if (g == 2) pool_rows<8>(X, rl, PA, r0, tseq0, av, c0);
        else pool_rows<16>(X, rl, PA, r0, tseq0, av, c0);
    }
}

__device__ __forceinline__ void phase_final(const float* X, const float* rowss, const float* g, float* out, int wg, int G) {
    const int tid = opaque_v((int)threadIdx.x), wave = __builtin_amdgcn_readfirstlane(tid >> 6), lane = tid & 63;
    const int gw = wg * 8 + wave, NGW = G * 8;
    f32x4 gv[8];
#pragma unroll
    for (int j = 0; j < 8; ++j) gv[j] = *(const f32x4*)(g + 4 * lane + 256 * j);
    for (int r = gw; r < M; r += NGW) {
        const float rs = __builtin_amdgcn_rsqf(rowss[r] * INV_D + EPS);
        const f32x4* xr = (const f32x4*)(X + (size_t)r * D) + lane; f32x4* orow = (f32x4*)(out + (size_t)r * D) + lane;
#pragma unroll
        for (int j = 0; j < 8; ++j) orow[64 * j] = xr[64 * j] * rs * gv[j];
    }
}

constexpr int NPH = 2 + 3 * NSB + 1;
struct Args { const float* in[17]; float* out; unsigned char* ws; int ph_lo, ph_hi; };
static_assert(sizeof(Args) == 17 * 8 + 8 + 8 + 8, "Args has no padding");

__global__ void __launch_bounds__(512, 2) mk_fwd(Args args) {
    extern __shared__ __attribute__((aligned(16))) unsigned char lds_raw[];
    LAS unsigned char* lds = (LAS unsigned char*)lds_raw;
    const int tid = threadIdx.x, G = gridDim.x, wg = blockIdx.x;
    const int lo = args.ph_lo, hi = args.ph_hi;
    unsigned char* ws = args.ws;
    Ptrs P;
    P.x = args.in[0]; P.c = args.in[1]; P.norm_ffn1 = args.in[2]; P.norm_mix = args.in[3]; P.norm_ffn2 = args.in[4]; P.w_ada = args.in[5]; P.b_ada = args.in[6];
    P.w_ffn1_in = args.in[7]; P.w_ffn1_out = args.in[8]; P.w_ffn2_in = args.in[9]; P.w_ffn2_out = args.in[10]; P.conv_in = args.in[11]; P.conv_w = args.in[12]; P.conv_out = args.in[13];
    P.pool_w = args.in[14]; P.pool_scale = args.in[15]; P.final_norm = args.in[16]; P.out = args.out; P.ws = ws;
    float* mods = (float*)(ws + WS_MODS);
    float* rowss = (float*)(ws + WS_ROWSS);
    float* X = (float*)(ws + WS_X);
    bf16_t* XA = (bf16_t*)(ws + WS_XA);
    bf16_t* HID = (bf16_t*)(ws + WS_HID);
    bf16_t* Ub = (bf16_t*)(ws + WS_U);
    bf16_t* BGb = (bf16_t*)(ws + WS_BG);
    bf16_t* ZA = (bf16_t*)(ws + WS_ZA);

    const bool use_bar = (hi - lo) > 1;
    XcdBarrier bar; bar.bar = (unsigned*)(ws + WS_CTL); bar.x = 0; bar.st = (volatile LAS unsigned*)(lds + LDS_MISC);
    if (use_bar) {
        if (tid == 0) { *(LAS u32x4*)(lds + LDS_MISC) = (u32x4){0u, 0u, 0u, 0u}; }
        __syncthreads();
        bar = xcd_barrier_post((unsigned*)(ws + WS_CTL), (volatile LAS unsigned*)(lds + LDS_MISC));
    }
#define IN(k) (lo <= (k) && (k) < hi)
#define SEAM(k) do { if (use_bar && (k) + 1 < hi) xcd_barrier(bar); } while (0)

    if (IN(0)) { phase_mods(lds, P.c, P.w_ada, P.b_ada, mods, wg, G); SEAM(0); }
    if (IN(1)) { phase_weights(lds, P, wg, G); SEAM(1); }

    for (int sbi = 0; sbi < NSB; ++sbi) {
        const int sb = opaque_s(sbi);
        ws = opaque_p(ws); mods = (float*)(ws + WS_MODS); rowss = (float*)(ws + WS_ROWSS); X = (float*)(ws + WS_X); XA = (bf16_t*)(ws + WS_XA); HID = (bf16_t*)(ws + WS_HID); Ub = (bf16_t*)(ws + WS_U); BGb = (bf16_t*)(ws + WS_BG); ZA = (bf16_t*)(ws + WS_ZA);
        const int l = sb / 3, s = sb - 3 * l, jm = l >> 1;
        const int type = (s != 1) ? 0 : ((l & 1) ? 2 : 1);
        const int p0 = 2 + 3 * sb;
        const float* modl = mods + (size_t)l * NB * MODS_LD;
        if (type != 2 && IN(p0)) {
            const bool ffn = (type == 0);
            const int mat = l * 2 + (s >> 1);
            const bf16_t* Bt = ffn ? (const bf16_t*)(ws + WS_WIN + (size_t)mat * WIN_BYTES) : (const bf16_t*)(ws + WS_WCVI + (size_t)jm * WCVI_BYTES);
            const int N = ffn ? 2 * F : 3 * D;
            const float* bias = ffn ? (const float*)(ws + WS_BIAS_IN) + (size_t)mat * NB * 2 * F : (const float*)(ws + WS_BIAS_CV) + (size_t)jm * NB * 3 * D;
            const pg8::Gemm g{XA, Bt, M, N, D, D, 0};
            const pg8::EpiGate E{ffn ? HID : Ub, ffn ? HID : BGb, rowss + (size_t)sb * M, bias, ffn ? F : D, ffn ? F : D, ffn ? 2 * F / 256 : 2 * D / 256, ffn ? 1 : 0, N};
            pg8::StaticOrder S; S.init(M, N, G, wg);
            pg8::gemm_phase<pg8::EpiGate, true, true>(lds, g, S, E);
            SEAM(p0);
        }
        if (type != 0 && IN(p0 + 1)) {
            if (type == 1) phase_conv(Ub, BGb, ZA, P.conv_w + (size_t)jm * 3 * D, wg, G);
            else phase_pool(lds, X, rowss + (size_t)sb * M, ZA, P.norm_mix + (size_t)l * D, modl + 4 * D, wg, G);
            SEAM(p0 + 1);
        }
        if (IN(p0 + 2)) {
            const int mat = l * 2 + (s >> 1);
            const bf16_t* A = (type == 0) ? HID : ZA;
            const int lda = (type == 0) ? F : D, K = (type == 0) ? F : ((type == 1) ? D : 512), gt = (type == 2) ? 2 : 0;
            const bf16_t* Bt = (type == 0) ? (const bf16_t*)(ws + WS_WOUT + (size_t)mat * WOUT_BYTES) : ((type == 1) ? (const bf16_t*)(ws + WS_WCVO + (size_t)jm * WCVO_BYTES) : (const bf16_t*)(ws + WS_WPOOL + (size_t)jm * WPOOL_BYTES));
            const float coef = (type == 0) ? 0.5f : 1.0f;
            const float* pscale = (type == 2) ? P.pool_scale + (size_t)jm * D : nullptr;
            const int sn = sb + 1, ln = sn / 3, ss2 = sn - 3 * ln;
            const bool has_xa = (sn < NSB) && !((ss2 == 1) && (ln & 1));
            const float* gain_next = (ss2 == 0 ? P.norm_ffn1 : (ss2 == 1 ? P.norm_mix : P.norm_ffn2)) + (size_t)(has_xa ? ln : 0) * D;
            const float* scale_next = mods + (size_t)(has_xa ? ln : 0) * NB * MODS_LD + (size_t)(3 * ss2 + 1) * D;
            const pg8::Gemm g{A, Bt, M, D, K, lda, gt};
            const pg8::EpiRes E{(sb == 0) ? P.x : X, X, has_xa ? XA : nullptr, rowss + (size_t)(sb + 1) * M, modl + (size_t)(3 * s + 2) * D, pscale, gain_next, scale_next, coef};
            pg8::StaticOrder S; S.init(M, D, G, wg);
            pg8::gemm_phase<pg8::EpiRes, true, true>(lds, g, S, E);
            SEAM(p0 + 2);
        }
    }
    if (IN(NPH - 1)) phase_final(X, rowss + (size_t)NSB * M, P.final_norm, P.out, wg, G);
#undef IN
#undef SEAM
}

static bool phase_exists(int p) {
    if (p < 2 || p == NPH - 1) return true;
    const int sb = (p - 2) / 3, j = (p - 2) % 3, l = sb / 3, s = sb % 3;
    const int type = (s != 1) ? 0 : ((l & 1) ? 2 : 1);
    if (j == 0) return type != 2;
    if (j == 1) return type != 0;
    return true;
}

extern "C" void kernel_launch(void* const* d_in, const int* in_sizes, int n_in, void* d_out, int out_size, void* d_ws, size_t ws_size, hipStream_t stream) {
    static int grid = 0;
    if (grid == 0) {
        if (n_in != 17 || in_sizes[0] != M * D || out_size != M * D || ws_size < WS_END) {
            fprintf(stderr, "kernel_launch: unexpected problem: n_in %d in0 %d out %d ws %zu (need %zu)\n", n_in, n_in > 0 ? in_sizes[0] : -1, out_size, ws_size, (size_t)WS_END); grid = -1; return; }
        int dev = 0, cus = 0, per_cu = 0;
        if (hipGetDevice(&dev) != hipSuccess || hipDeviceGetAttribute(&cus, hipDeviceAttributeMultiprocessorCount, dev) != hipSuccess) { fprintf(stderr, "kernel_launch: device query failed\n"); grid = -1; return; }
        if (hipFuncSetAttribute((const void*)mk_fwd, hipFuncAttributeMaxDynamicSharedMemorySize, LDS_BYTES) != hipSuccess) { fprintf(stderr, "kernel_launch: hipFuncSetAttribute failed\n"); grid = -1; return; }
        if (hipOccupancyMaxActiveBlocksPerMultiprocessor(&per_cu, (const void*)mk_fwd, 512, LDS_BYTES) != hipSuccess || per_cu < 1) {
            fprintf(stderr, "kernel_launch: occupancy query reports %d workgroups per CU\n", per_cu); }
        (void)hipGetLastError();
        grid = cus;
    }
    if (grid < 0) return;
    if (hipMemsetAsync((char*)d_ws, 0, ZERO_BYTES, stream) != hipSuccess) { fprintf(stderr, "kernel_launch: memset failed\n"); return; }
    Args a{};
    for (int i = 0; i < 17; ++i) a.in[i] = (const float*)d_in[i];
    a.out = (float*)d_out; a.ws = (unsigned char*)d_ws;
#if MK_PER_PHASE
    for (int p = 0; p < NPH; ++p) {
        if (!phase_exists(p)) continue;
        a.ph_lo = p; a.ph_hi = p + 1;
        hipLaunchKernelGGL(mk_fwd, dim3(grid), dim3(512), LDS_BYTES, stream, a);
    }
#else
    a.ph_lo = 0; a.ph_hi = NPH;
    hipLaunchKernelGGL(mk_fwd, dim3(grid), dim3(512), LDS_BYTES, stream, a);
#endif
    const hipError_t le = hipPeekAtLastError();
    if (le != hipSuccess) fprintf(stderr, "kernel_launch: launch failed: %s\n", hipGetErrorName(le));
}
```
